# Optimizing an MI355X kernel written in HIP

```python
import math
import jax, jax.numpy as jnp
from jax import lax
import numpy as np

D_MODEL = 1024
BATCH = 8
SEQ = 2048
DEPTH = 1

D_MIX = D_MODEL
MOBA_HEADS = 8
MOBA_HEAD_DIM = 64
D_MOBA = MOBA_HEADS * MOBA_HEAD_DIM
GMLP_GROUPS = 8
GMLP_GROUP_DIM = 64
D_GMLP = GMLP_GROUPS * GMLP_GROUP_DIM
D_IN_PROJ = 3 * D_MOBA + 2 * D_GMLP

MOBA_BLOCK = 256
MOBA_TOPK = 3
Q_CHUNK = 128
GMLP_CHUNK = 128

NUM_BUCKETS = 32
REL_MAX_DISTANCE = 128

D_FF = -(-(8 * D_MODEL) // (3 * 256)) * 256
EPS = 1e-6
NEG = -1e9

kernel_name = 'hybrid_moba_chunked_gmlp_block'


def rms_norm(x, g):
    xf = x.astype(jnp.float32)
    y = xf * lax.rsqrt(jnp.mean(xf * xf, axis=-1, keepdims=True) + EPS)
    return (y * g.astype(jnp.float32)).astype(x.dtype)


def layer_norm(x, g, b):
    xf = x.astype(jnp.float32)
    mu = jnp.mean(xf, axis=-1, keepdims=True)
    var = jnp.mean(jnp.square(xf - mu), axis=-1, keepdims=True)
    y = (xf - mu) * lax.rsqrt(var + EPS)
    return (y * g.astype(jnp.float32) + b.astype(jnp.float32)).astype(x.dtype)


def t5_bucket(dist):
    n = jnp.maximum(dist, 0)
    max_exact = NUM_BUCKETS // 2
    nf = jnp.maximum(n, max_exact).astype(jnp.float32)
    large = max_exact + (jnp.log(nf / max_exact) / math.log(REL_MAX_DISTANCE / max_exact)
                         * (NUM_BUCKETS - max_exact)).astype(jnp.int32)
    large = jnp.minimum(large, NUM_BUCKETS - 1)
    return jnp.where(n < max_exact, n, large)


def moba_attention(q, k, v, rel_bias):
    B, S, H, D = q.shape
    S_pad = -(-S // MOBA_BLOCK) * MOBA_BLOCK
    pad = S_pad - S
    q, k, v = [jnp.pad(t, ((0, 0), (0, pad), (0, 0), (0, 0))).transpose(0, 2, 1, 3)
               for t in (q, k, v)]
    NB = S_pad // MOBA_BLOCK
    k_blk = k.reshape(B, H, NB, MOBA_BLOCK, D)
    v_blk = v.reshape(B, H, NB, MOBA_BLOCK, D)
    k_mean = jnp.mean(k_blk.astype(jnp.float32), axis=3)
    gate = jnp.einsum('bhsd,bhnd->bhsn', q.astype(jnp.float32), k_mean)
    q_block = jnp.arange(S_pad) // MOBA_BLOCK
    past = jnp.arange(NB)[None, :] < q_block[:, None]
    gate = jnp.where(past[None, None], gate, NEG)
    topk = min(MOBA_TOPK, NB)
    _, top_idx = lax.top_k(gate, topk)
    valid = jnp.arange(topk)[None, :] < q_block[:, None]
    bias_hb = rel_bias.T.astype(jnp.float32)
    NC = S_pad // Q_CHUNK
    scale = D ** -0.5
    h_ix = jnp.arange(H)[:, None, None]
    l_idx = jnp.arange(MOBA_BLOCK)

    def step(idx):
        b, c = idx
        q0 = c * Q_CHUNK
        q_c = lax.dynamic_slice(q, (b, 0, q0, 0), (1, H, Q_CHUNK, D))[0]
        sel = lax.dynamic_slice(top_idx, (b, 0, q0, 0), (1, H, Q_CHUNK, topk))[0]
        ok = lax.dynamic_slice(valid, (q0, 0), (Q_CHUNK, topk))
        kb = k_blk[b]
        vb = v_blk[b]
        k_sel = kb[h_ix, sel]
        v_sel = vb[h_ix, sel]
        own = q0 // MOBA_BLOCK
        k_own = lax.dynamic_index_in_dim(kb, own, axis=1, keepdims=False)
        v_own = lax.dynamic_index_in_dim(vb, own, axis=1, keepdims=False)
        q_pos = q0 + jnp.arange(Q_CHUNK)
        pos_sel = sel[..., None] * MOBA_BLOCK + l_idx
        dist_sel = q_pos[None, :, None, None] - pos_sel
        b_sel = bias_hb[h_ix[..., None], t5_bucket(dist_sel)]
        dist_own = q_pos[:, None] - (own * MOBA_BLOCK + l_idx)[None, :]
        b_own = bias_hb[:, t5_bucket(dist_own)]
        l_sel = jnp.einsum('hqd,hqkld->hqkl', q_c, k_sel).astype(jnp.float32) * scale + b_sel
        l_sel = jnp.where(ok[None, :, :, None], l_sel, NEG)
        l_own = jnp.einsum('hqd,hld->hql', q_c, k_own).astype(jnp.float32) * scale + b_own
        l_own = jnp.where((dist_own >= 0)[None], l_own, NEG)
        logits = jnp.concatenate([l_sel.reshape(H, Q_CHUNK, topk * MOBA_BLOCK), l_own], axis=-1)
        p = jax.nn.softmax(logits, axis=-1).astype(v.dtype)
        p_sel = p[..., :topk * MOBA_BLOCK].reshape(H, Q_CHUNK, topk, MOBA_BLOCK)
        p_own = p[..., topk * MOBA_BLOCK:]
        return (jnp.einsum('hqkl,hqkld->hqd', p_sel, v_sel)
                + jnp.einsum('hql,hld->hqd', p_own, v_own))

    b_ids = jnp.repeat(jnp.arange(B), NC)
    c_ids = jnp.tile(jnp.arange(NC), B)
    out = lax.map(step, (b_ids, c_ids))
    out = out.reshape(B, NC, H, Q_CHUNK, D).transpose(0, 1, 3, 2, 4).reshape(B, S_pad, H * D)
    return out[:, :S]


def chunked_gmlp(u, z, ln_g, ln_b, w_spatial, b_spatial):
    B, S, _ = z.shape
    u = jax.nn.gelu(u)
    z = layer_norm(jax.nn.gelu(z), ln_g, ln_b)
    n_ch = S // GMLP_CHUNK
    z = z.reshape(B, n_ch, GMLP_CHUNK, GMLP_GROUPS, GMLP_GROUP_DIM)
    causal = jnp.tril(jnp.ones((GMLP_CHUNK, GMLP_CHUNK), dtype=z.dtype))
    w = w_spatial.astype(z.dtype) * causal
    s = jnp.einsum('gts,bcsgd->bctgd', w, z) + b_spatial.T.astype(z.dtype)[:, :, None]
    return u * s.reshape(B, S, D_GMLP)


def setup_inputs(seed: int = 0) -> dict:
    key = jax.random.key(seed)
    ks = jax.random.split(key, 16)

    def nrm(k, shape, scale):
        return jax.random.normal(k, shape, jnp.float32) * scale

    return {
        'x': nrm(ks[0], (BATCH, SEQ, D_MODEL), 1.0),
        'rel_bias': nrm(ks[1], (NUM_BUCKETS, MOBA_HEADS), 0.3),
        'norm_mix': 1.0 + nrm(ks[2], (DEPTH, D_MODEL), 0.05),
        'w_in': nrm(ks[3], (DEPTH, D_MODEL, D_IN_PROJ), D_MODEL ** -0.5),
        'gmlp_ln_g': 1.0 + nrm(ks[4], (DEPTH, D_GMLP), 0.05),
        'gmlp_ln_b': nrm(ks[5], (DEPTH, D_GMLP), 0.02),
        'w_spatial': nrm(ks[6], (DEPTH, GMLP_GROUPS, GMLP_CHUNK, GMLP_CHUNK), GMLP_CHUNK ** -0.5),
        'b_spatial': 1.0 + nrm(ks[7], (DEPTH, GMLP_GROUPS, GMLP_CHUNK), 0.1),
        'out_norm_b': 1.0 + nrm(ks[8], (DEPTH, D_MOBA), 0.05),
        'out_norm_a': 1.0 + nrm(ks[9], (DEPTH, D_GMLP), 0.05),
        'w_out': nrm(ks[10], (DEPTH, D_MIX, D_MODEL), D_MIX ** -0.5),
        'norm_ffn': 1.0 + nrm(ks[11], (DEPTH, D_MODEL), 0.05),
        'w_gate': nrm(ks[12], (DEPTH, D_MODEL, D_FF), D_MODEL ** -0.5),
        'w_up': nrm(ks[13], (DEPTH, D_MODEL, D_FF), D_MODEL ** -0.5),
        'w_down': nrm(ks[14], (DEPTH, D_FF, D_MODEL), D_FF ** -0.5),
        'norm_final': 1.0 + nrm(ks[15], (D_MODEL,), 0.05),
    }


def reference(x, rel_bias, norm_mix, w_in, gmlp_ln_g, gmlp_ln_b, w_spatial, b_spatial,
              out_norm_b, out_norm_a, w_out, norm_ffn, w_gate, w_up, w_down, norm_final):
    B, S, _ = x.shape
    for l in range(DEPTH):
        h = rms_norm(x, norm_mix[l])
        proj = h @ w_in[l]
        q, k, v, u, z = jnp.split(
            proj, [D_MOBA, 2 * D_MOBA, 3 * D_MOBA, 3 * D_MOBA + D_GMLP], axis=-1)
        shp = (B, S, MOBA_HEADS, MOBA_HEAD_DIM)
        y_b = moba_attention(q.reshape(shp), k.reshape(shp), v.reshape(shp), rel_bias)
        y_a = chunked_gmlp(u, z, gmlp_ln_g[l], gmlp_ln_b[l], w_spatial[l], b_spatial[l])
        y = jnp.concatenate([rms_norm(y_b, out_norm_b[l]), rms_norm(y_a, out_norm_a[l])], axis=-1)
        x = x + y @ w_out[l]
        h = rms_norm(x, norm_ffn[l])
        x = x + (jax.nn.silu(h @ w_gate[l]) * (h @ w_up[l])) @ w_down[l]
    return rms_norm(x, norm_final)
```

```cpp
#include <hip/hip_runtime.h>
#include <cstdio>
#include <cstdint>

namespace nv {
constexpr int B_ = 8, S_ = 2048, D_ = 1024, M_ = B_ * S_, H_ = 8, HD = 64, DP = 2560, FF_ = 2816, NB = 8;
constexpr float EPS = 1e-6f;

__device__ __forceinline__ float gelu_tanh(float x) { const float u = 0.7978845608028654f * (x + 0.044715f * x * x * x); return 0.5f * x * (1.f + tanhf(u)); }
__device__ __forceinline__ float wsum(float v) {
#pragma unroll
    for (int o = 1; o < 64; o <<= 1) v += __shfl_xor(v, o);
    return v; }
__device__ __forceinline__ float wmax(float v) {
#pragma unroll
    for (int o = 1; o < 64; o <<= 1) v = fmaxf(v, __shfl_xor(v, o));
    return v; }

template <int NCOLS>
__global__ void k_rmsnorm(const float* x, int ldx, const float* g, float* out, int ldo, int nrows) {
    const int row = blockIdx.x * 4 + (threadIdx.x >> 6), lane = threadIdx.x & 63; if (row >= nrows) return;
    const float* xr = x + (size_t)row * ldx; constexpr int per = NCOLS / 64; float v[per]; float s = 0.f;
#pragma unroll
    for (int j = 0; j < per; ++j) { v[j] = xr[lane + 64 * j]; s += v[j] * v[j]; }
    const float r = rsqrtf(wsum(s) / (float)NCOLS + EPS);
    float* o = out + (size_t)row * ldo;
#pragma unroll
    for (int j = 0; j < per; ++j) o[lane + 64 * j] = v[j] * r * g[lane + 64 * j];
}

template <int MODE>
__global__ void __launch_bounds__(256) k_gemm(const float* __restrict__ A, int lda, const float* __restrict__ Bm, const float* __restrict__ B2, int ldb, float* C, int ldc, const float* R, int K) {
    __shared__ float As[16][128 + 4]; __shared__ float Bs[16][128 + 4]; __shared__ float Bs2[MODE == 2 ? 16 : 1][128 + 4];
    const int tid = threadIdx.x, tx = tid & 15, ty = tid >> 4; const int m0 = blockIdx.y * 128, n0 = blockIdx.x * 128;
    float acc[8][8], acc2[MODE == 2 ? 8 : 1][8];
#pragma unroll
    for (int i = 0; i < 8; ++i)
#pragma unroll
        for (int j = 0; j < 8; ++j) { acc[i][j] = 0.f; if (MODE == 2) acc2[i][j] = 0.f; }
    for (int k0 = 0; k0 < K; k0 += 16) {
#pragma unroll
        for (int i = 0; i < 2; ++i) { const int e = tid + 256 * i, r = e >> 2, c4 = (e & 3) * 4; const float4 a = *(const float4*)(A + (size_t)(m0 + r) * lda + k0 + c4);
            As[c4 + 0][r] = a.x; As[c4 + 1][r] = a.y; As[c4 + 2][r] = a.z; As[c4 + 3][r] = a.w; }
#pragma unroll
        for (int i = 0; i < 2; ++i) { const int e = tid + 256 * i, r = e >> 5, c4 = (e & 31) * 4; *(float4*)&Bs[r][c4] = *(const float4*)(Bm + (size_t)(k0 + r) * ldb + n0 + c4);
            if (MODE == 2) *(float4*)&Bs2[r][c4] = *(const float4*)(B2 + (size_t)(k0 + r) * ldb + n0 + c4); }
        __syncthreads();
#pragma unroll
        for (int kk = 0; kk < 16; ++kk) {
            float a[8], b[8], b2[8];
#pragma unroll
            for (int i = 0; i < 8; ++i) a[i] = As[kk][ty * 8 + i];
#pragma unroll
            for (int j = 0; j < 8; ++j) { b[j] = Bs[kk][tx * 8 + j]; if (MODE == 2) b2[j] = Bs2[kk][tx * 8 + j]; }
#pragma unroll
            for (int i = 0; i < 8; ++i)
#pragma unroll
                for (int j = 0; j < 8; ++j) { acc[i][j] += a[i] * b[j]; if (MODE == 2) acc2[i][j] += a[i] * b2[j]; }
        }
        __syncthreads();
    }
#pragma unroll
    for (int i = 0; i < 8; ++i)
#pragma unroll
        for (int j = 0; j < 8; ++j) { const size_t off = (size_t)(m0 + ty * 8 + i) * ldc + n0 + tx * 8 + j; float v = acc[i][j];
            if (MODE == 1) v += R[off];
            if (MODE == 2) { const float gte = acc[i][j]; v = gte / (1.f + expf(-gte)) * acc2[i][j]; }
            C[off] = v; }
}

__global__ void k_kmean(const float* P, float* kmean) {
    const int bn = blockIdx.x, b = bn / NB, n = bn % NB; const int c = threadIdx.x;
    float s = 0.f; for (int r = 0; r < 256; ++r) s += P[(size_t)(b * S_ + n * 256 + r) * DP + 512 + c];
    kmean[((size_t)(b * H_ + c / 64) * NB + n) * 64 + (c % 64)] = s * (1.f / 256.f);
}

__device__ __forceinline__ int t5_bucket(int n) { if (n < 16) return n; const float nf = (float)n; int l = 16 + (int)(logf(nf / 16.f) / logf(8.f) * 16.f); return l < 31 ? l : 31; }

__global__ void __launch_bounds__(64) k_moba(const float* P, const float* kmean, const float* rel_bias, float* Y, int ldy) {
    __shared__ float qs[64]; __shared__ float ps[1024]; __shared__ int blk[4];
    const int s = blockIdx.x, h = blockIdx.y, b = blockIdx.z, lane = threadIdx.x; const int qb = s >> 8; const size_t m = (size_t)b * S_ + s;
    const float qv = P[m * DP + h * 64 + lane]; qs[lane] = qv;
    float gate[8];
#pragma unroll
    for (int n = 0; n < 8; ++n) { const float kv = (n < qb) ? kmean[((size_t)(b * H_ + h) * NB + n) * 64 + lane] : 0.f; gate[n] = wsum(qv * kv); }
    int nsel = 0;
    if (lane == 0) {
#pragma unroll
        for (int n = 0; n < 8; ++n) { if (n < qb) { int rank = 0;
#pragma unroll
            for (int j = 0; j < 8; ++j) if (j < qb && (gate[j] > gate[n] || (gate[j] == gate[n] && j < n))) ++rank;
            if (rank < 3) blk[nsel++] = n; } }
        blk[nsel++] = qb;
        for (int i = nsel; i < 4; ++i) blk[i] = -1;
    }
    __syncthreads();
    float lg[16]; float mx = -3.0e38f;
#pragma unroll
    for (int bi = 0; bi < 4; ++bi) { const int n = blk[bi];
#pragma unroll
        for (int j = 0; j < 4; ++j) { float v = -3.0e38f;
            if (n >= 0) { const int kpos = n * 256 + j * 64 + lane; const int dist = s - kpos;
                if (dist >= 0) { const float* kr = P + ((size_t)b * S_ + kpos) * DP + 512 + h * 64; float a = 0.f; for (int d = 0; d < 64; ++d) a += qs[d] * kr[d];
                    v = a * 0.125f + rel_bias[t5_bucket(dist) * H_ + h]; } }
            lg[bi * 4 + j] = v; mx = fmaxf(mx, v); } }
    mx = wmax(mx); float sum = 0.f;
#pragma unroll
    for (int i = 0; i < 16; ++i) { const float e = (lg[i] > -1.0e38f) ? expf(lg[i] - mx) : 0.f; lg[i] = e; sum += e; }
    sum = wsum(sum); const float inv = 1.f / sum;
#pragma unroll
    for (int i = 0; i < 16; ++i) ps[i * 64 + lane] = lg[i] * inv;
    __syncthreads();
    float o = 0.f;
    for (int bi = 0; bi < 4; ++bi) { const int n = blk[bi]; if (n < 0) continue;
        const float* vb = P + ((size_t)b * S_ + n * 256) * DP + 1024 + h * 64 + lane;
        for (int j = 0; j < 256; ++j) o += ps[bi * 256 + j] * vb[(size_t)j * DP]; }
    Y[m * ldy + h * 64 + lane] = o;
}

__global__ void k_zn(float* P, const float* lng, const float* lnb) {
    const int row = blockIdx.x * 4 + (threadIdx.x >> 6), lane = threadIdx.x & 63; float* pr = P + (size_t)row * DP;
    float v[8]; float s = 0.f;
#pragma unroll
    for (int j = 0; j < 8; ++j) { v[j] = gelu_tanh(pr[2048 + lane + 64 * j]); s += v[j]; }
    const float mu = wsum(s) * (1.f / 512.f); float q = 0.f;
#pragma unroll
    for (int j = 0; j < 8; ++j) { const float d = v[j] - mu; q += d * d; }
    const float r = rsqrtf(wsum(q) * (1.f / 512.f) + EPS);
#pragma unroll
    for (int j = 0; j < 8; ++j) { const int c = lane + 64 * j; pr[2048 + c] = (v[j] - mu) * r * lng[c] + lnb[c]; pr[1536 + c] = gelu_tanh(pr[1536 + c]); }
}
__global__ void k_gmlp(const float* P, const float* wsp, const float* bsp, float* Y, int ldy) {
    const int m = blockIdx.x, c = threadIdx.x, g = c >> 6, t = m & 127, m0 = m - t;
    const float* w = wsp + ((size_t)g * 128 + t) * 128; float a = 0.f;
    for (int s = 0; s <= t; ++s) a += w[s] * P[(size_t)(m0 + s) * DP + 2048 + c];
    Y[(size_t)m * ldy + 512 + c] = P[(size_t)m * DP + 1536 + c] * (a + bsp[g * 128 + t]);
}
}

extern "C" void kernel_launch(void* const* d_in, const int* in_sizes, int n_in, void* d_out, int out_size, void* d_ws, size_t ws_size, hipStream_t stream) {
    using namespace nv;
    const float* x = (const float*)d_in[0]; const float* rel_bias = (const float*)d_in[1]; const float* norm_mix = (const float*)d_in[2]; const float* w_in = (const float*)d_in[3];
    const float* lng = (const float*)d_in[4]; const float* lnb = (const float*)d_in[5]; const float* wsp = (const float*)d_in[6]; const float* bsp = (const float*)d_in[7];
    const float* onb = (const float*)d_in[8]; const float* ona = (const float*)d_in[9]; const float* w_out = (const float*)d_in[10]; const float* norm_ffn = (const float*)d_in[11];
    const float* w_gate = (const float*)d_in[12]; const float* w_up = (const float*)d_in[13]; const float* w_down = (const float*)d_in[14]; const float* norm_final = (const float*)d_in[15];
    float* out = (float*)d_out; float* ws = (float*)d_ws;
    const size_t MiBf = (1u << 20) / 4;
    float* Hb = ws;
    float* Pb = ws + 64 * MiBf;
    float* km = ws + 240 * MiBf;
    float* Yb = Hb; float* FFb = Pb;
    k_rmsnorm<1024><<<M_ / 4, 256, 0, stream>>>(x, D_, norm_mix, Hb, D_, M_);
    k_gemm<0><<<dim3(DP / 128, M_ / 128), 256, 0, stream>>>(Hb, D_, w_in, nullptr, DP, Pb, DP, nullptr, D_);
    k_kmean<<<B_ * NB, 512, 0, stream>>>(Pb, km);
    k_moba<<<dim3(S_, H_, B_), 64, 0, stream>>>(Pb, km, rel_bias, Yb, D_);
    k_zn<<<M_ / 4, 256, 0, stream>>>(Pb, lng, lnb);
    k_gmlp<<<M_, 512, 0, stream>>>(Pb, wsp, bsp, Yb, D_);
    k_rmsnorm<512><<<M_ / 4, 256, 0, stream>>>(Yb, D_, onb, Yb, D_, M_);
    k_rmsnorm<512><<<M_ / 4, 256, 0, stream>>>(Yb + 512, D_, ona, Yb + 512, D_, M_);
    k_gemm<1><<<dim3(D_ / 128, M_ / 128), 256, 0, stream>>>(Yb, D_, w_out, nullptr, D_, out, D_, x, D_);
    k_rmsnorm<1024><<<M_ / 4, 256, 0, stream>>>(out, D_, norm_ffn, Hb, D_, M_);
    k_gemm<2><<<dim3(FF_ / 128, M_ / 128), 256, 0, stream>>>(Hb, D_, w_gate, w_up, FF_, FFb, FF_, nullptr, D_);
    k_gemm<1><<<dim3(D_ / 128, M_ / 128), 256, 0, stream>>>(FFb, FF_, w_down, nullptr, D_, out, D_, out, FF_);
    k_rmsnorm<1024><<<M_ / 4, 256, 0, stream>>>(out, D_, norm_final, out, D_, M_);
}
```

```cpp
#include <hip/hip_runtime.h>
#include <cstdio>
#include <cstdint>
namespace pg8 {
#define PG8_LAS __attribute__((address_space(3)))
typedef unsigned short bf16_t;
typedef short bf16x8 __attribute__((ext_vector_type(8)));
typedef float f32x4 __attribute__((ext_vector_type(4)));
typedef unsigned u32x4 __attribute__((ext_vector_type(4)));
constexpr int BM = 256, BK = 64, HALF = 128, HTB = HALF * BK * 2  , STAGE_BYTES = 8 * HTB, NXCD = 8, WGM = 8;

__host__ __device__ __forceinline__ int lds_byte(int r, int c) { const int st = (r >> 4) * 2 + (c >> 5), rr = r & 15, cc = c & 31, ob = rr * 64 + cc * 2; return st * 1024 + (ob ^ (((ob >> 9) & 1) << 5)); }
__host__ __device__ __forceinline__ void stage_rc(int b, int& R, int& C) { const int st = b / 1024, sb = b % 1024, swz = sb ^ (((sb >> 9) & 1) << 5); R = (st >> 1) * 16 + swz / 64; C = (st & 1) * 32 + (swz % 64) / 2; }
__host__ __device__ __forceinline__ int perm32(int rho) { const int n = rho >> 4, i = rho & 15; return 8 * (i >> 2) + 4 * n + (i & 3); }

struct Unit { int pm, pn; };
struct Gemm { const bf16_t* A; const bf16_t* Bt; int M, N, K; };

struct StaticOrder {
    int nM, nN, nwg, G, c;
    __host__ __device__ void init(int M, int N, int G_, int c_) { nM = M / BM; nN = N / BM; nwg = nM * nN; G = G_; c = c_; }
    __host__ __device__ bool next(int i, Unit& u) const {
        const long L = (long)i * G + c; if (L >= nwg) return false;
        int wgid = (int)L; { const int q = nwg / NXCD, r = nwg % NXCD, xcd = wgid % NXCD, off = wgid / NXCD; wgid = (xcd < r ? xcd * (q + 1) : r * (q + 1) + (xcd - r) * q) + off; }
        const int nig = WGM * nN, gid = wgid / nig, fm = gid * WGM, gsz = (nM - fm) < WGM ? (nM - fm) : WGM;
        u.pm = fm + ((wgid % nig) % gsz); u.pn = (wgid % nig) / gsz; return true;
    }
    __device__ __forceinline__ void a_ready(const Unit&) const {}
    __device__ __forceinline__ void done(const Unit&) const {}
};

__device__ __forceinline__ unsigned cvt_pk_bf16(float lo, float hi) { unsigned r; asm volatile("v_cvt_pk_bf16_f32 %0, %1, %2" : "=v"(r) : "v"(lo), "v"(hi)); return r; }
typedef float f32x2 __attribute__((ext_vector_type(2)));
typedef unsigned u32x2 __attribute__((ext_vector_type(2)));
constexpr int DP = 2560, FFD = 2816;
__device__ __forceinline__ float gelu_tanh_f(float x) {
    const float t = x * (2.3022082f + 0.10294324f * x * x);
    return x * __builtin_amdgcn_rcpf(1.0f + __builtin_amdgcn_exp2f(-t));
}
__device__ __forceinline__ float silu_f(float x) { return x * __builtin_amdgcn_rcpf(1.0f + __builtin_amdgcn_exp2f(-1.4426950408889634f * x)); }

struct EpiInProj {
    static constexpr bool PERM = true, AFTER_DRAIN = false, MIDK = false; static constexpr int MIDK_TILE = 0;
    bf16_t* P; float* ksum; float* zst; float qscale;
    __device__ __forceinline__ void operator()(const f32x4 (&acc)[2][2][4][2], const Unit& u, int ui, int wr, int wc, int fr, int fq) const {
        const int pn = u.pn, kind = pn >> 1; const int row0 = u.pm * BM + wr * 64 + fr; const int col0 = pn * BM + wc * 32 + 8 * fq;
        if (kind <= 2) {
            const float sc = (kind == 0) ? qscale : 1.f;
#pragma unroll
            for (int ai = 0; ai < 2; ++ai)
#pragma unroll
                for (int m = 0; m < 4; ++m) { bf16_t* rowp = P + (size_t)(row0 + ai * HALF + m * 16) * DP + col0;
#pragma unroll
                    for (int bj = 0; bj < 2; ++bj) { const f32x4 v0 = acc[ai][bj][m][0] * sc, v1 = acc[ai][bj][m][1] * sc;
                        u32x4 w; w.x = cvt_pk_bf16(v0[0], v0[1]); w.y = cvt_pk_bf16(v0[2], v0[3]); w.z = cvt_pk_bf16(v1[0], v1[1]); w.w = cvt_pk_bf16(v1[2], v1[3]);
                        *(u32x4*)(rowp + bj * HALF) = w; } }
            if (kind == 1) {
#pragma unroll
                for (int bj = 0; bj < 2; ++bj)
#pragma unroll
                    for (int n = 0; n < 2; ++n) { f32x4 cs = (f32x4){0.f, 0.f, 0.f, 0.f};
#pragma unroll
                        for (int ai = 0; ai < 2; ++ai)
#pragma unroll
                            for (int m = 0; m < 4; ++m) cs += acc[ai][bj][m][n];
#pragma unroll
                        for (int o = 1; o < 16; o <<= 1) { cs[0] += __shfl_xor(cs[0], o); cs[1] += __shfl_xor(cs[1], o); cs[2] += __shfl_xor(cs[2], o); cs[3] += __shfl_xor(cs[3], o); }
                        if (fr == 0) *(f32x4*)(ksum + (size_t)(u.pm * 2 + wr) * 512 + (pn - 2) * BM + bj * HALF + wc * 32 + 8 * fq + 4 * n) = cs; }
            }
        } else {
#pragma unroll
            for (int ai = 0; ai < 2; ++ai)
#pragma unroll
                for (int m = 0; m < 4; ++m) { const int row = row0 + ai * HALF + m * 16; bf16_t* rowp = P + (size_t)row * DP + col0; float s1 = 0.f, s2 = 0.f;
#pragma unroll
                    for (int bj = 0; bj < 2; ++bj) { f32x4 v0 = acc[ai][bj][m][0], v1 = acc[ai][bj][m][1];
#pragma unroll
                        for (int j = 0; j < 4; ++j) { v0[j] = gelu_tanh_f(v0[j]); v1[j] = gelu_tanh_f(v1[j]); s1 += v0[j] + v1[j]; s2 += v0[j] * v0[j] + v1[j] * v1[j]; }
                        u32x4 w; w.x = cvt_pk_bf16(v0[0], v0[1]); w.y = cvt_pk_bf16(v0[2], v0[3]); w.z = cvt_pk_bf16(v1[0], v1[1]); w.w = cvt_pk_bf16(v1[2], v1[3]);
                        *(u32x4*)(rowp + bj * HALF) = w; }
                    if (kind == 4) { s1 += __shfl_xor(s1, 16); s1 += __shfl_xor(s1, 32); s2 += __shfl_xor(s2, 16); s2 += __shfl_xor(s2, 32);
                        if (fq == 0) *(f32x2*)(zst + ((size_t)row * 8 + (pn - 8) * 4 + wc) * 2) = (f32x2){s1, s2}; } }
        }
    }
};

struct EpiOutProj {
    static constexpr bool PERM = false, AFTER_DRAIN = false, MIDK = true; static constexpr int MIDK_TILE = 8;
    const float* x; float* x1; bf16_t* xn; float* ssq1; const PG8_LAS float* tab;
    __device__ __forceinline__ void midk(f32x4 (&acc)[2][2][4][2], int ui, int wr, int fr) const {
#pragma unroll
        for (int ai = 0; ai < 2; ++ai)
#pragma unroll
            for (int m = 0; m < 4; ++m) { const float f = tab[ui * 512 + ai * HALF + wr * 64 + m * 16 + fr];
#pragma unroll
                for (int bj = 0; bj < 2; ++bj)
#pragma unroll
                    for (int n = 0; n < 2; ++n) acc[ai][bj][m][n] *= f; }
    }
    __device__ __forceinline__ void operator()(const f32x4 (&acc)[2][2][4][2], const Unit& u, int ui, int wr, int wc, int fr, int fq) const {
        const int col0 = u.pn * BM + wc * 32 + 4 * fq;
#pragma unroll
        for (int ai = 0; ai < 2; ++ai)
#pragma unroll
            for (int m = 0; m < 4; ++m) { const int rl = ai * HALF + wr * 64 + m * 16 + fr; const float ra = tab[ui * 512 + 256 + rl]; const size_t rowoff = (size_t)(u.pm * BM + rl) * 1024 + col0; float ss = 0.f;
#pragma unroll
                for (int bj = 0; bj < 2; ++bj)
#pragma unroll
                    for (int n = 0; n < 2; ++n) { const size_t off = rowoff + bj * HALF + n * 16; const f32x4 o = *(const f32x4*)(x + off) + acc[ai][bj][m][n] * ra;
                        *(f32x4*)(x1 + off) = o; u32x2 w; w.x = cvt_pk_bf16(o[0], o[1]); w.y = cvt_pk_bf16(o[2], o[3]); *(u32x2*)(xn + off) = w;
                        ss += (o[0] * o[0] + o[1] * o[1]) + (o[2] * o[2] + o[3] * o[3]); }
                ss += __shfl_xor(ss, 16); ss += __shfl_xor(ss, 32);
                if (fq == 0) ssq1[(size_t)(u.pm * BM + rl) * 16 + u.pn * 4 + wc] = ss; }
    }
};

struct EpiSwiGLU {
    static constexpr bool PERM = true, AFTER_DRAIN = false, MIDK = false; static constexpr int MIDK_TILE = 0;
    bf16_t* Hb; const PG8_LAS float* tab;
    __device__ __forceinline__ void operator()(const f32x4 (&acc)[2][2][4][2], const Unit& u, int ui, int wr, int wc, int fr, int fq) const {
        const int col0 = u.pn * HALF + wc * 32 + 8 * fq;
#pragma unroll
        for (int ai = 0; ai < 2; ++ai)
#pragma unroll
            for (int m = 0; m < 4; ++m) { const int rl = ai * HALF + wr * 64 + m * 16 + fr; const float r = tab[ui * 256 + rl];
                f32x4 h0, h1;
#pragma unroll
                for (int j = 0; j < 4; ++j) { h0[j] = silu_f(acc[ai][0][m][0][j] * r) * (acc[ai][1][m][0][j] * r); h1[j] = silu_f(acc[ai][0][m][1][j] * r) * (acc[ai][1][m][1][j] * r); }
                u32x4 w; w.x = cvt_pk_bf16(h0[0], h0[1]); w.y = cvt_pk_bf16(h0[2], h0[3]); w.z = cvt_pk_bf16(h1[0], h1[1]); w.w = cvt_pk_bf16(h1[2], h1[3]);
                *(u32x4*)(Hb + (size_t)(u.pm * BM + rl) * FFD + col0) = w; }
    }
};

struct EpiDown {
    static constexpr bool PERM = false, AFTER_DRAIN = false, MIDK = false; static constexpr int MIDK_TILE = 0;
    float* x1;
    __device__ __forceinline__ void operator()(const f32x4 (&acc)[2][2][4][2], const Unit& u, int ui, int wr, int wc, int fr, int fq) const {
        const int col0 = u.pn * BM + wc * 32 + 4 * fq;
#pragma unroll
        for (int ai = 0; ai < 2; ++ai)
#pragma unroll
            for (int m = 0; m < 4; ++m) { const size_t rowoff = (size_t)(u.pm * BM + ai * HALF + wr * 64 + m * 16 + fr) * 1024 + col0;
#pragma unroll
                for (int bj = 0; bj < 2; ++bj)
#pragma unroll
                    for (int n = 0; n < 2; ++n) { const size_t off = rowoff + bj * HALF + n * 16; *(f32x4*)(x1 + off) = *(const f32x4*)(x1 + off) + acc[ai][bj][m][n]; } }
    }
};

template <class Epi, class Sched, bool ALIGN_EPI = false, bool SP2 = false>
__device__ __forceinline__ void gemm_phase(PG8_LAS unsigned char* lds, const Gemm g, const Sched& S, const Epi& E) {
    const int tid = threadIdx.x, wid = __builtin_amdgcn_readfirstlane(tid >> 6), lane = tid & 63, wr = wid >> 2, wc = wid & 3, fr = lane & 15, fq = lane >> 4;
    const int K = g.K, nt = K / BK;
    unsigned voffA[2], voffB[2];
#pragma unroll
    for (int i = 0; i < 2; ++i) { int R, C; stage_rc(tid * 16 + i * 8192, R, C); const int Rb = Epi::PERM ? ((R & ~31) + perm32(R & 31)) : R;
        voffA[i] = (unsigned)(R * K + C) * 2u; voffB[i] = (unsigned)(Rb * K + C) * 2u; }
    const size_t kstep = (size_t)(BK * 2);
    const size_t hstep = (size_t)HALF * K * 2;
    const size_t tstep = 2 * hstep;
    const unsigned ldsw = (unsigned)wid * 1024u;
    const int aoff = lds_byte(wr * 64 + fr, fq * 8), boff = lds_byte(wc * 32 + fr, fq * 8);
#define PG8_SA(b, h) (((b) * 2 + (h)) * HTB)
#define PG8_SB(b, h) ((4 + (b) * 2 + (h)) * HTB)
#define PG8_STAGE(bufoff, gbase, voff) do { _Pragma("unroll") for (int _i = 0; _i < 2; ++_i) \
        __builtin_amdgcn_global_load_lds((const unsigned*)((const char*)(gbase) + (voff)[_i]), (PG8_LAS unsigned*)(lds + (bufoff) + ldsw + _i * 8192), 16, 0, 0); } while (0)
#define PG8_LDA(dst, b, h) do { _Pragma("unroll") for (int m = 0; m < 4; ++m) _Pragma("unroll") for (int k = 0; k < 2; ++k) dst[m][k] = *(const PG8_LAS bf16x8*)(lds + PG8_SA(b, h) + aoff + m * 2048 + k * 1024); } while (0)
#define PG8_LDB(dst, b, h) do { _Pragma("unroll") for (int n = 0; n < 2; ++n) _Pragma("unroll") for (int k = 0; k < 2; ++k) dst[n][k] = *(const PG8_LAS bf16x8*)(lds + PG8_SB(b, h) + boff + n * 2048 + k * 1024); } while (0)
#define PG8_MMA(ai, bj, At, Bt) do { __builtin_amdgcn_s_setprio(1); _Pragma("unroll") for (int m = 0; m < 4; ++m) _Pragma("unroll") for (int n = 0; n < 2; ++n) _Pragma("unroll") for (int k = 0; k < 2; ++k) \
        acc[ai][bj][m][n] = __builtin_amdgcn_mfma_f32_16x16x32_bf16(Bt[n][k], At[m][k], acc[ai][bj][m][n], 0, 0, 0); __builtin_amdgcn_s_setprio(0); } while (0)
#define PG8_WAIT_V(n) asm volatile("s_waitcnt vmcnt(" #n ")" ::: "memory")
#define PG8_WAIT_L(n) asm volatile("s_waitcnt lgkmcnt(" #n ")" ::: "memory")
#define PG8_BAR __builtin_amdgcn_s_barrier()
#define PG8_SCHED __builtin_amdgcn_sched_barrier(0)
    Unit cur, nxt; int ui = 0;
    if (!S.next(0, cur)) return;
    f32x4 acc[2][2][4][2];
#pragma unroll
    for (int a = 0; a < 2; ++a)
#pragma unroll
        for (int b = 0; b < 2; ++b)
#pragma unroll
            for (int m = 0; m < 4; ++m)
#pragma unroll
                for (int n = 0; n < 2; ++n) acc[a][b][m][n] = (f32x4){0.f, 0.f, 0.f, 0.f};
    bf16x8 At[4][2], B0[2][2], B1[2][2];
    const char* cA = (const char*)g.A + (size_t)cur.pm * tstep; const char* cB = (const char*)g.Bt + (size_t)cur.pn * tstep;
    S.a_ready(cur);
    if constexpr (SP2) {
        PG8_STAGE(PG8_SB(0, 0), cB, voffB); PG8_STAGE(PG8_SB(0, 1), cB + hstep, voffB); PG8_STAGE(PG8_SA(0, 0), cA, voffA); PG8_STAGE(PG8_SA(0, 1), cA + hstep, voffA);
        if (wr == 1) PG8_BAR;
        PG8_WAIT_V(2); PG8_BAR;
        PG8_STAGE(PG8_SB(1, 0), cB + kstep, voffB); PG8_STAGE(PG8_SA(1, 0), cA + kstep, voffA); PG8_STAGE(PG8_SB(1, 1), cB + hstep + kstep, voffB);
        PG8_WAIT_V(6); PG8_BAR;
    } else {
        PG8_STAGE(PG8_SB(0, 0), cB, voffB); PG8_STAGE(PG8_SA(0, 0), cA, voffA); PG8_STAGE(PG8_SB(0, 1), cB + hstep, voffB); PG8_STAGE(PG8_SA(0, 1), cA + hstep, voffA);
        if (wr == 1) PG8_BAR;
        PG8_WAIT_V(4); PG8_BAR;
        PG8_STAGE(PG8_SB(1, 0), cB + kstep, voffB); PG8_STAGE(PG8_SA(1, 0), cA + kstep, voffA); PG8_STAGE(PG8_SB(1, 1), cB + hstep + kstep, voffB);
        PG8_WAIT_V(6); PG8_BAR;
    }
    for (;;) {
        const bool has_next = S.next(ui + 1, nxt);
        const char* nA = has_next ? (const char*)g.A + (size_t)nxt.pm * tstep : cA; const char* nB = has_next ? (const char*)g.Bt + (size_t)nxt.pn * tstep : cB;
        for (int t = 0; t < nt; t += 2) {
            const bool last = (t == nt - 2);
            if constexpr (Epi::MIDK) { if (t == Epi::MIDK_TILE) E.midk(acc, ui, wr, fr); }
            const char* a1 = cA + (size_t)(t + 1) * kstep;
            const char* a2 = last ? nA : cA + (size_t)(t + 2) * kstep; const char* b2 = last ? nB : cB + (size_t)(t + 2) * kstep;
            const char* a3 = a2 + kstep; const char* b3 = b2 + kstep;
            if (last && has_next) S.a_ready(nxt);
            if constexpr (SP2) {
            PG8_LDB(B0, 0, 0); PG8_LDB(B1, 0, 1); PG8_SCHED; PG8_LDA(At, 0, 0); PG8_STAGE(PG8_SA(1, 1), a1 + hstep, voffA);
            PG8_WAIT_V(8); PG8_WAIT_L(0); PG8_BAR; PG8_MMA(0, 0, At, B0); PG8_MMA(0, 1, At, B1); PG8_BAR; PG8_SCHED;
            PG8_LDA(At, 0, 1); PG8_STAGE(PG8_SB(0, 0), b2, voffB); PG8_STAGE(PG8_SB(0, 1), b2 + hstep, voffB); PG8_STAGE(PG8_SA(0, 0), a2, voffA);
            PG8_WAIT_V(8); PG8_WAIT_L(0); PG8_BAR; PG8_MMA(1, 0, At, B0); PG8_MMA(1, 1, At, B1); PG8_BAR; PG8_SCHED;
            PG8_LDB(B0, 1, 0); PG8_LDB(B1, 1, 1); PG8_SCHED; PG8_LDA(At, 1, 0); PG8_STAGE(PG8_SA(0, 1), a2 + hstep, voffA);
            PG8_WAIT_V(8); PG8_WAIT_L(0); PG8_BAR; PG8_MMA(0, 0, At, B0); PG8_MMA(0, 1, At, B1); PG8_BAR; PG8_SCHED;
            PG8_LDA(At, 1, 1); PG8_STAGE(PG8_SB(1, 0), b3, voffB); PG8_STAGE(PG8_SB(1, 1), b3 + hstep, voffB); PG8_STAGE(PG8_SA(1, 0), a3, voffA);
            PG8_WAIT_V(8); PG8_WAIT_L(0); PG8_BAR; PG8_MMA(1, 0, At, B0); PG8_MMA(1, 1, At, B1); PG8_BAR; PG8_SCHED;
            } else {
            PG8_LDB(B0, 0, 0); PG8_SCHED; PG8_LDA(At, 0, 0); PG8_STAGE(PG8_SA(1, 1), a1 + hstep, voffA);
            PG8_WAIT_L(8); PG8_BAR; PG8_WAIT_L(0); PG8_MMA(0, 0, At, B0); PG8_BAR; PG8_SCHED;
            PG8_LDB(B1, 0, 1); PG8_STAGE(PG8_SB(0, 0), b2, voffB);
            PG8_BAR; PG8_WAIT_L(0); PG8_MMA(0, 1, At, B1); PG8_BAR;
            PG8_LDA(At, 0, 1); PG8_STAGE(PG8_SA(0, 0), a2, voffA);
            PG8_BAR; PG8_WAIT_L(0); PG8_MMA(1, 0, At, B0); PG8_BAR; PG8_SCHED;
            PG8_STAGE(PG8_SB(0, 1), b2 + hstep, voffB);
            PG8_WAIT_V(6); PG8_BAR; PG8_MMA(1, 1, At, B1); PG8_BAR;
            PG8_LDB(B0, 1, 0); PG8_SCHED; PG8_LDA(At, 1, 0); PG8_STAGE(PG8_SA(0, 1), a2 + hstep, voffA);
            PG8_WAIT_L(8); PG8_BAR; PG8_WAIT_L(0); PG8_MMA(0, 0, At, B0); PG8_BAR; PG8_SCHED;
            PG8_LDB(B1, 1, 1); PG8_STAGE(PG8_SB(1, 0), b3, voffB);
            PG8_BAR; PG8_WAIT_L(0); PG8_MMA(0, 1, At, B1); PG8_BAR;
            PG8_LDA(At, 1, 1); PG8_STAGE(PG8_SA(1, 0), a3, voffA);
            PG8_BAR; PG8_WAIT_L(0); PG8_MMA(1, 0, At, B0); PG8_BAR; PG8_SCHED;
            PG8_STAGE(PG8_SB(1, 1), b3 + hstep, voffB);
            PG8_WAIT_V(6); PG8_BAR; PG8_MMA(1, 1, At, B1); PG8_BAR;
            }
        }
        if constexpr (ALIGN_EPI) { if (wr == 0) PG8_BAR; }
        if constexpr (!Epi::AFTER_DRAIN) { E(acc, cur, ui, wr, wc, fr, fq); S.done(cur); }
        if (!has_next) break;
#pragma unroll
        for (int a = 0; a < 2; ++a)
#pragma unroll
            for (int b = 0; b < 2; ++b)
#pragma unroll
                for (int m = 0; m < 4; ++m)
#pragma unroll
                    for (int n = 0; n < 2; ++n) acc[a][b][m][n] = (f32x4){0.f, 0.f, 0.f, 0.f};
        cur = nxt; cA = nA; cB = nB; ++ui;
        if constexpr (ALIGN_EPI) { if (wr == 1) PG8_BAR; }
    }
    PG8_WAIT_V(0);
    if constexpr (!ALIGN_EPI) { if (wr == 0) PG8_BAR; }
    PG8_BAR;
    if constexpr (Epi::AFTER_DRAIN) { E.fused(acc, cur, wr, wc, fr, fq, lds, wid, lane); S.done(cur); }
#undef PG8_SA
#undef PG8_SB
#undef PG8_STAGE
#undef PG8_LDA
#undef PG8_LDB
#undef PG8_MMA
#undef PG8_WAIT_V
#undef PG8_WAIT_L
#undef PG8_BAR
#undef PG8_SCHED
}
}
namespace att {
#define ALAS __attribute__((address_space(3)))
typedef unsigned short bf16;
using bf16x8 = __attribute__((ext_vector_type(8))) short;
using s16x4 = __attribute__((ext_vector_type(4))) short;
using f32x16 = __attribute__((ext_vector_type(16))) float;
using f32x4 = __attribute__((ext_vector_type(4))) float;
using u32x4 = __attribute__((ext_vector_type(4))) unsigned;
typedef ALAS const char* lds_cptr;
constexpr int SEQ = 2048, DP = 2560, YP = 1024;
constexpr int SLOTB = 8192;
constexpr int L_K = 0, L_V = 2 * SLOTB, L_WS = 4 * SLOTB, L_OST = L_WS + 8 * 256, L_KM = L_OST + 8 * 4096, L_TAB = L_KM + 2048, L_END = L_TAB + 2048;
constexpr float LOG2E = 1.4426950408889634f;
constexpr float C2 = 0.125f * LOG2E;
constexpr float THR = 8.f;
constexpr float MASKV = -1.0e30f;
__device__ __forceinline__ int crow(int r, int hi) { return (r & 3) + 8 * (r >> 2) + 4 * hi; }
__device__ __forceinline__ unsigned f2bf(float f) { unsigned u = __builtin_bit_cast(unsigned, f); return (u + 0x7fffu + ((u >> 16) & 1u)) >> 16; }
__device__ __forceinline__ float bf2f(unsigned short h) { return __builtin_bit_cast(float, (unsigned)h << 16); }
typedef float f32x2_t __attribute__((ext_vector_type(2))); typedef __bf16 bf16x2_t __attribute__((ext_vector_type(2)));
__device__ __forceinline__ unsigned cvtpk_s(float lo, float hi) { f32x2_t v = {lo, hi}; bf16x2_t b = __builtin_convertvector(v, bf16x2_t); return __builtin_bit_cast(unsigned, b); }
__device__ __forceinline__ void glds16(const void* gsrc, unsigned lds_dst) { unsigned keep;
    asm volatile("s_mov_b32 %0, m0\n\ts_mov_b32 m0, %2\n\ts_nop 0\n\tglobal_load_lds_dwordx4 %1, off\n\ts_mov_b32 m0, %0" : "=&s"(keep) : "v"(gsrc), "s"(lds_dst) : "memory"); }
#define AMX3(a, b, c) __builtin_fmaxf(__builtin_fmaxf((a), (b)), (c))
__device__ __forceinline__ float rowmax(const f32x16& p0, const f32x16& p1) {
    float a = AMX3(p0[0], p0[1], p1[0]), b = AMX3(p0[2], p0[3], p1[1]); a = AMX3(a, p1[2], p1[3]);
#pragma unroll
    for (int r = 4; r < 16; r += 4) { a = AMX3(a, p0[r], p0[r + 1]); b = AMX3(b, p0[r + 2], p0[r + 3]); a = AMX3(a, p1[r], p1[r + 1]); b = AMX3(b, p1[r + 2], p1[r + 3]); }
    const float m = __builtin_fmaxf(a, b); return __builtin_fmaxf(m, __shfl_xor(m, 32)); }
__device__ __forceinline__ void qkt(f32x16& p0, f32x16& p1, lds_cptr kb, const bf16x8* qr, const f32x16& c) {
#pragma unroll
    for (int d0 = 0; d0 < 4; ++d0) {
        const bf16x8 b0 = *(const ALAS bf16x8*)(kb + d0 * 2048), b1 = *(const ALAS bf16x8*)(kb + d0 * 2048 + 512);
        if (d0 == 0) { p0 = __builtin_amdgcn_mfma_f32_32x32x16_bf16(b0, qr[0], c, 0, 0, 0); p1 = __builtin_amdgcn_mfma_f32_32x32x16_bf16(b1, qr[0], c, 0, 0, 0); }
        else { p0 = __builtin_amdgcn_mfma_f32_32x32x16_bf16(b0, qr[d0], p0, 0, 0, 0); p1 = __builtin_amdgcn_mfma_f32_32x32x16_bf16(b1, qr[d0], p1, 0, 0, 0); } }
}
__device__ __forceinline__ void pv(f32x16* o, int vb, bf16x8 pa0, bf16x8 pa1, bf16x8 pa2, bf16x8 pa3) {
#pragma unroll
    for (int d0 = 0; d0 < 2; ++d0) { s16x4 lo[4], hi[4];
#pragma unroll
        for (int ks = 0; ks < 4; ++ks) {
            asm volatile("ds_read_b64_tr_b16 %0,%1 offset:%c2" : "=&v"(lo[ks]) : "v"(vb), "i"(d0 * 4096 + ks * 1024) : "memory");
            asm volatile("ds_read_b64_tr_b16 %0,%1 offset:%c2" : "=&v"(hi[ks]) : "v"(vb), "i"(d0 * 4096 + ks * 1024 + 512) : "memory"); }
        asm volatile("s_waitcnt lgkmcnt(0)" ::: "memory"); __builtin_amdgcn_sched_barrier(0);
#define APK(k) (bf16x8){lo[k][0], lo[k][1], lo[k][2], lo[k][3], hi[k][0], hi[k][1], hi[k][2], hi[k][3]}
        o[d0] = __builtin_amdgcn_mfma_f32_32x32x16_bf16(pa0, APK(0), o[d0], 0, 0, 0);
        o[d0] = __builtin_amdgcn_mfma_f32_32x32x16_bf16(pa1, APK(1), o[d0], 0, 0, 0);
        o[d0] = __builtin_amdgcn_mfma_f32_32x32x16_bf16(pa2, APK(2), o[d0], 0, 0, 0);
        o[d0] = __builtin_amdgcn_mfma_f32_32x32x16_bf16(pa3, APK(3), o[d0], 0, 0, 0);
#undef APK
    }
}
__device__ __forceinline__ int t5_bucket(int n) { if (n < 16) return n; const int l = 16 + (int)(logf((float)n / 16.f) / logf(8.f) * 16.f); return l < 31 ? l : 31; }

__device__ __forceinline__ void moba_unit(int b, int h, int qb, const bf16* PB, const float* ksum, const float* rel_bias, bf16* YB, float* ssqb, ALAS char* shm) {
    const int tid = threadIdx.x, lane = tid & 63, r32 = lane & 31, hi = lane >> 5; const int wid = __builtin_amdgcn_readfirstlane(tid >> 6);
    const long rowbase = (long)b * SEQ; const int q0 = qb * 256, q0w = q0 + wid * 32, qpos = q0w + r32;
    const bf16* Qw = PB + (rowbase + q0w) * DP + h * 64;
    const bf16* Kh = PB + rowbase * DP + 512 + h * 64; const bf16* Vh = Kh + 512;
    const unsigned lds0 = (unsigned)(uintptr_t)shm;
    ALAS float* wsf = (ALAS float*)(shm + L_WS) + wid * 64; ALAS float* km = (ALAS float*)(shm + L_KM); ALAS float* tab = (ALAS float*)(shm + L_TAB);
    const bf16* ksrc = Kh + (long)lane * DP + wid * 8;
    const bf16* vsrc = Vh + (long)(16 * (wid & 3) + (lane >> 2)) * DP + (wid >> 2) * 32 + (lane & 3) * 8;
    const unsigned kdst = lds0 + L_K + wid * 1024, vdst = lds0 + L_V + wid * 1024;
#define DMA_K(t, slot) glds16(ksrc + (long)(t) * 64 * DP, (unsigned)__builtin_amdgcn_readfirstlane(kdst + (slot)))
#define DMA_V(t, slot) glds16(vsrc + (long)(t) * 64 * DP, (unsigned)__builtin_amdgcn_readfirstlane(vdst + (slot)))
    const int vb0 = (int)(lds0 + L_V) + ((lane >> 4) & 1) * 32 + (lane & 3) * 8 + (4 * hi + ((lane & 15) >> 2)) * 64;
    const lds_cptr kp0 = (lds_cptr)shm + L_K + hi * 1024 + r32 * 16;
    const int NT = 4 * (qb + 1);
    DMA_K(4 * qb, 0); DMA_V(4 * qb, 0);
    {
        const int n = tid >> 6, d = tid & 63; float v = 0.f;
        if (n < qb) { const float* p = ksum + (size_t)((b * 8 + n) * 2) * 512 + h * 64 + d; v = (p[0] + p[512]) * (1.0f / 256.0f); }
        km[tid] = v;
        const int dd = tid - 128; float tv;
        if (dd < 0) tv = MASKV; else if (dd >= 113) tv = 0.f; else tv = (rel_bias[t5_bucket(dd) * 8 + h] - rel_bias[31 * 8 + h]) * LOG2E;
        tab[tid] = tv;
    }
    bf16x8 qr[4];
#pragma unroll
    for (int d0 = 0; d0 < 4; ++d0) qr[d0] = *reinterpret_cast<const bf16x8*>(&Qw[(long)r32 * DP + d0 * 16 + hi * 8]);
    __syncthreads();
    unsigned selmask = 0u;
    {   float g[7];
#pragma unroll
        for (int n = 0; n < 7; ++n) { float a = 0.f;
            if (n < qb) {
#pragma unroll
                for (int d0 = 0; d0 < 4; ++d0)
#pragma unroll
                    for (int j = 0; j < 8; ++j) a += bf2f((unsigned short)qr[d0][j]) * km[n * 64 + 16 * d0 + 8 * hi + j]; }
            a += __shfl_xor(a, 32); g[n] = a; }
#pragma unroll
        for (int n = 0; n < 7; ++n) if (n < qb) { int rank = 0;
#pragma unroll
            for (int j = 0; j < 7; ++j) if (j < qb) rank += (g[j] > g[n] || (g[j] == g[n] && j < n)) ? 1 : 0;
            if (rank < 3) selmask |= 1u << n; }
    }
    float mhat = 0.f, l_reg = 0.f; f32x16 o[2];
#pragma unroll
    for (int r = 0; r < 16; ++r) { o[0][r] = 0.f; o[1][r] = 0.f; }
    for (int i = 0; i < NT; ++i) {
        asm volatile("s_waitcnt vmcnt(0) lgkmcnt(0)\n\ts_barrier" ::: "memory");
        if (i + 1 < NT) { const int tn = (i + 1 < 4) ? 4 * qb + i + 1 : i + 1 - 4; const unsigned so = (unsigned)((i + 1) & 1) * SLOTB; DMA_K(tn, so); DMA_V(tn, so); }
        const int t = (i < 4) ? 4 * qb + i : i - 4, k0 = t * 64, slot = (i & 1) * SLOTB; const bool own = i < 4;
        if (own && k0 > q0w) continue;
        f32x16 c; { const bool sel = own || ((selmask >> (t >> 2)) & 1u); const float cv = (i == 0) ? 0.f : (sel ? -mhat : MASKV);
#pragma unroll
            for (int r = 0; r < 16; ++r) c[r] = cv; }
        f32x16 p0, p1; qkt(p0, p1, kp0 + slot, qr, c);
        if (own || (q0w - k0 < 176)) {
            const int ib = qpos - k0 + 128 - 4 * hi;
#pragma unroll
            for (int r = 0; r < 16; ++r) { const int cc = (r & 3) + 8 * (r >> 2); p0[r] += tab[ib - cc]; p1[r] += tab[ib - cc - 32]; } }
        const float rm = rowmax(p0, p1);
        if (i == 0) { mhat = rm;
#pragma unroll
            for (int r = 0; r < 16; ++r) { p0[r] -= rm; p1[r] -= rm; } }
        else if (__any(rm > THR)) { const float dl = __builtin_fmaxf(rm, 0.f); mhat += dl;
#pragma unroll
            for (int r = 0; r < 16; ++r) { p0[r] -= dl; p1[r] -= dl; }
            const float f = __builtin_amdgcn_exp2f(-dl); l_reg *= f; if (hi == 0) wsf[r32] = f;
            asm volatile("s_waitcnt lgkmcnt(0)" ::: "memory");
#pragma unroll
            for (int r = 0; r < 16; ++r) { const float fr_ = wsf[crow(r, hi)]; o[0][r] *= fr_; o[1][r] *= fr_; } }
        float sacc = 0.f;
#pragma unroll
        for (int r = 0; r < 16; ++r) { p0[r] = __builtin_amdgcn_exp2f(p0[r]); p1[r] = __builtin_amdgcn_exp2f(p1[r]); sacc += p0[r] + p1[r]; }
        l_reg += sacc;
        const u32x4 pw0 = (u32x4){cvtpk_s(p0[0], p0[1]), cvtpk_s(p0[2], p0[3]), cvtpk_s(p0[4], p0[5]), cvtpk_s(p0[6], p0[7])};
        const u32x4 pw1 = (u32x4){cvtpk_s(p0[8], p0[9]), cvtpk_s(p0[10], p0[11]), cvtpk_s(p0[12], p0[13]), cvtpk_s(p0[14], p0[15])};
        const u32x4 pw2 = (u32x4){cvtpk_s(p1[0], p1[1]), cvtpk_s(p1[2], p1[3]), cvtpk_s(p1[4], p1[5]), cvtpk_s(p1[6], p1[7])};
        const u32x4 pw3 = (u32x4){cvtpk_s(p1[8], p1[9]), cvtpk_s(p1[10], p1[11]), cvtpk_s(p1[12], p1[13]), cvtpk_s(p1[14], p1[15])};
        pv(o, vb0 + slot, __builtin_bit_cast(bf16x8, pw0), __builtin_bit_cast(bf16x8, pw1), __builtin_bit_cast(bf16x8, pw2), __builtin_bit_cast(bf16x8, pw3));
    }
    l_reg += __shfl_xor(l_reg, 32);
    if (hi == 0) wsf[32 + r32] = l_reg;
    asm volatile("s_waitcnt lgkmcnt(0)" ::: "memory");
    {   ALAS bf16* stg = (ALAS bf16*)(shm + L_OST) + wid * 2048;
#pragma unroll
        for (int r = 0; r < 16; ++r) { const int orow = crow(r, hi); const float rl = __builtin_amdgcn_rcpf(wsf[32 + orow]);
#pragma unroll
            for (int d0 = 0; d0 < 2; ++d0) stg[orow * 64 + d0 * 32 + r32] = (bf16)f2bf(o[d0][r] * rl); }
        asm volatile("s_waitcnt lgkmcnt(0)" ::: "memory");
        bf16* Ow = YB + (rowbase + q0w) * YP + h * 64;
#pragma unroll
        for (int i = 0; i < 4; ++i) { const int row = i * 8 + (lane >> 3), ch = lane & 7; const u32x4 v = *(const ALAS u32x4*)(stg + row * 64 + ch * 8);
            *(u32x4*)(Ow + (long)row * YP + ch * 8) = v;
            float ss = 0.f;
#pragma unroll
            for (int j = 0; j < 4; ++j) { const float a = __builtin_bit_cast(float, v[j] << 16), bq = __builtin_bit_cast(float, v[j] & 0xffff0000u); ss += a * a + bq * bq; }
            ss += __shfl_xor(ss, 1); ss += __shfl_xor(ss, 2); ss += __shfl_xor(ss, 4);
            if (ch == 0) ssqb[(size_t)(rowbase + q0w + row) * 8 + h] = ss; } }
    asm volatile("s_waitcnt lgkmcnt(0)\n\ts_barrier" ::: "memory");
#undef DMA_K
#undef DMA_V
}

__device__ __forceinline__ void gmlp_item(int b, int c, int g, const bf16* PB, const float* zst, const float* lng, const float* lnb, const bf16* wsp, const float* bsp, bf16* YB, float* ssqa, ALAS char* shm) {
    const int tid = threadIdx.x, lane = tid & 63, r32 = lane & 31, hi = lane >> 5; const int wid = __builtin_amdgcn_readfirstlane(tid >> 6);
    const size_t m0 = (size_t)b * SEQ + c * 128;
    ALAS bf16* zT = (ALAS bf16*)shm; ALAS bf16* yst = (ALAS bf16*)(shm + 20480);
    {   const int s = tid >> 2, cq = (tid & 3) * 16; const size_t m = m0 + s;
        const u32x4 za = *(const u32x4*)(PB + m * DP + 2048 + g * 64 + cq), zb = *(const u32x4*)(PB + m * DP + 2048 + g * 64 + cq + 8);
        const f32x4* sp = (const f32x4*)(zst + m * 16); float s1 = 0.f, s2 = 0.f;
#pragma unroll
        for (int k = 0; k < 4; ++k) { const f32x4 q = sp[k]; s1 += q[0] + q[2]; s2 += q[1] + q[3]; }
        const float mu = s1 * (1.0f / 512.0f); const float var = s2 * (1.0f / 512.0f) - mu * mu; const float rstd = 1.0f / sqrtf(var + 1e-6f);
#pragma unroll
        for (int j = 0; j < 8; ++j) { const unsigned w = (j < 4) ? za[j & 3] : zb[j & 3];
            const int col = cq + 2 * j; const float z0 = __builtin_bit_cast(float, w << 16), z1 = __builtin_bit_cast(float, w & 0xffff0000u);
            const float n0 = (z0 - mu) * rstd * lng[g * 64 + col] + lnb[g * 64 + col], n1 = (z1 - mu) * rstd * lng[g * 64 + col + 1] + lnb[g * 64 + col + 1];
            zT[col * 136 + s] = (bf16)f2bf(n0); zT[(col + 1) * 136 + s] = (bf16)f2bf(n1); }
    }
    __syncthreads();
    {   const int ti = wid >> 1, dj = wid & 1, t0 = 32 * ti, d0 = 32 * dj; f32x16 acc;
#pragma unroll
        for (int r = 0; r < 16; ++r) acc[r] = 0.f;
        const bf16* wrow = wsp + ((size_t)g * 128 + t0 + r32) * 128 + 8 * hi; const ALAS bf16* zrow = zT + (d0 + r32) * 136 + 8 * hi;
        const int nks = 2 * (ti + 1);
        for (int ks = 0; ks < nks; ++ks) { const bf16x8 a = *(const bf16x8*)(wrow + 16 * ks); const bf16x8 bq = *(const ALAS bf16x8*)(zrow + 16 * ks);
            acc = __builtin_amdgcn_mfma_f32_32x32x16_bf16(a, bq, acc, 0, 0, 0); }
#pragma unroll
        for (int r = 0; r < 16; ++r) { const int t = t0 + crow(r, hi), d = d0 + r32; const float sv = acc[r] + bsp[g * 128 + t];
            const float uv = bf2f(PB[(m0 + t) * DP + 1536 + g * 64 + d]); yst[t * 64 + d] = (bf16)f2bf(uv * sv); }
    }
    __syncthreads();
#pragma unroll
    for (int k = 0; k < 2; ++k) { const int id = tid + 512 * k, row = id >> 3, ch = id & 7; const u32x4 v = *(const ALAS u32x4*)(yst + row * 64 + ch * 8);
        *(u32x4*)(YB + (m0 + row) * YP + 512 + g * 64 + ch * 8) = v;
        float ss = 0.f;
#pragma unroll
        for (int j = 0; j < 4; ++j) { const float a = __builtin_bit_cast(float, v[j] << 16), bq = __builtin_bit_cast(float, v[j] & 0xffff0000u); ss += a * a + bq * bq; }
        ss += __shfl_xor(ss, 1); ss += __shfl_xor(ss, 2); ss += __shfl_xor(ss, 4);
        if (ch == 0) ssqa[(m0 + row) * 8 + g] = ss; }
    __syncthreads();
}
#undef AMX3
}

constexpr int NWAVES = 8;
constexpr int BATCH = 8, SEQ = 2048, DM = 1024, M = BATCH * SEQ, DPJ = 2560, FF = 2816;
constexpr float EPS = 1e-6f;
constexpr size_t MiB = 1u << 20;
constexpr size_t WS_CTL = 0, CTL_ZERO_BYTES = 1 * MiB;
constexpr size_t WS_KSUM = 1 * MiB;
constexpr size_t WS_ZST = 2 * MiB;
constexpr size_t WS_SSQB = 3 * MiB, WS_SSQA = WS_SSQB + 512 * 1024;
constexpr size_t WS_SSQ1 = 4 * MiB;
constexpr size_t WS_WSP = 5 * MiB;
constexpr size_t WS_WIN = 8 * MiB, WS_WOUT = 13 * MiB, WS_W1 = 15 * MiB, WS_W2 = 26 * MiB;
constexpr size_t WS_XN = 32 * MiB;
constexpr size_t WS_PB = 64 * MiB;
constexpr size_t WS_HB = 64 * MiB;
constexpr size_t WS_YB = 176 * MiB;
constexpr size_t WS_END = 208 * MiB;
static_assert(WS_W2 + (size_t)DM * FF * 2 <= WS_XN && WS_PB + (size_t)M * DPJ * 2 <= WS_YB && WS_HB + (size_t)M * FF * 2 <= WS_YB && WS_END <= 268435456, "d_ws map");
constexpr int CW_BAR = 4096;
constexpr int RING_OFF = 0, RING_BYTES = 131072;
constexpr int TAB_OFF = RING_BYTES;
constexpr int MISC_OFF = TAB_OFF + 12288;
constexpr int LDS_BYTES = 147456;
static_assert(MISC_OFF + 128 <= LDS_BYTES && att::L_END <= RING_BYTES, "LDS map");

#define GAS __attribute__((address_space(1)))
#define LAS __attribute__((address_space(3)))
typedef unsigned short bf16;
typedef unsigned v4u __attribute__((ext_vector_type(4)));
typedef float f32x4 __attribute__((ext_vector_type(4)));
typedef short bf16x8 __attribute__((ext_vector_type(8)));
typedef GAS unsigned gu32;
typedef GAS unsigned long long gu64;
#define RLX_AGENT __ATOMIC_RELAXED, __HIP_MEMORY_SCOPE_AGENT
#define LDS_WAIT() asm volatile("s_waitcnt lgkmcnt(0)" ::: "memory")
#define VM_WAIT() asm volatile("s_waitcnt vmcnt(0)" ::: "memory")
__device__ __forceinline__ unsigned long long rt() { return __builtin_amdgcn_s_memrealtime(); }
__device__ __forceinline__ unsigned f2bf(float f) { unsigned u = __builtin_bit_cast(unsigned, f); return (u + 0x7fffu + ((u >> 16) & 1u)) >> 16; }
__device__ __forceinline__ unsigned pk2(float lo, float hi) { return f2bf(lo) | (f2bf(hi) << 16); }

#define XB_TMO      128
#define XB_XCNT(j)  (256  + 64 * (j))
#define XB_XSUB(j)  (1280 + 64 * (j))
#define XB_XGEN(j)  (2304 + 64 * (j))
#define XB_TOP      3328
#define XB_TOPGEN   3392
#define XCD_BAR_WORDS 3456
#define XB_SPIN_CAP (1u << 18)

__device__ __forceinline__ unsigned xb_ld(unsigned* p)              { return __hip_atomic_load(p, __ATOMIC_RELAXED, __HIP_MEMORY_SCOPE_AGENT); }
__device__ __forceinline__ unsigned xb_add(unsigned* p, unsigned v) { return __hip_atomic_fetch_add(p, v, __ATOMIC_RELAXED, __HIP_MEMORY_SCOPE_AGENT); }
__device__ __forceinline__ unsigned xb_xcc_id() { return (unsigned)__builtin_amdgcn_s_getreg((3 << 11) | 20) & 0xFu; }
#define XB_SPIN(cond, bar) do { unsigned _sp = 0; while (cond) { __builtin_amdgcn_s_sleep(1); \
    if ((++_sp & 255u) == 0u) { if (xb_ld(&(bar)[XB_TMO])) break; if (_sp > XB_SPIN_CAP) { atomicAdd(&(bar)[XB_TMO], 1u); break; } } } } while (0)

struct XcdBarrier {
    unsigned* bar; unsigned x;
    volatile LAS unsigned* st;
};

__device__ __forceinline__ XcdBarrier xcd_barrier_post(unsigned* bar, volatile LAS unsigned* st) {
    XcdBarrier b; b.bar = bar; b.x = xb_xcc_id(); b.st = st;
    if (threadIdx.x == 0) (void)xb_add(&bar[XB_XCNT(b.x)], 1u);
    return b;
}
__device__ __forceinline__ void xcd_barrier_complete(unsigned* bar, unsigned x, unsigned& nloc, unsigned& nx) {
    const unsigned G = gridDim.x * gridDim.y * gridDim.z;
    unsigned sum, cnt, mine, sp = 0u;
    for (;;) {
        sum = 0u; cnt = 0u; mine = 0u;
#pragma unroll
        for (unsigned j = 0; j < 16; ++j) { const unsigned c = xb_ld(&bar[XB_XCNT(j)]); sum += c; cnt += (c > 0u) ? 1u : 0u; mine = (j == x) ? c : mine; }
        if (sum == G) break;
        __builtin_amdgcn_s_sleep(1);
        if ((++sp & 255u) == 0u) { if (xb_ld(&bar[XB_TMO])) break; if (sp > XB_SPIN_CAP) { atomicAdd(&bar[XB_TMO], 1u); break; } }
    }
    nloc = mine > 0u ? mine : 1u; nx = cnt > 0u ? cnt : 1u;
}

__device__ __forceinline__ void xcd_barrier(const XcdBarrier& b) {
    asm volatile("s_waitcnt vmcnt(0)" ::: "memory");
    __syncthreads();
    if (threadIdx.x == 0) {
        unsigned* bar = b.bar;
        __builtin_amdgcn_s_waitcnt(0);
        unsigned nloc = b.st[0], nx = b.st[1];
        if (nloc == 0u) { xcd_barrier_complete(bar, b.x, nloc, nx); b.st[0] = nloc; b.st[1] = nx; }
        const unsigned old = xb_add(&bar[XB_XSUB(b.x)], 1u);
        const unsigned gen = old / nloc;
        if (old + 1u == (gen + 1u) * nloc) {
            __builtin_amdgcn_fence(__ATOMIC_RELEASE, "agent");
            asm volatile("s_waitcnt vmcnt(0)" ::: "memory");
            const unsigned og = xb_add(&bar[XB_TOP], 1u);
            const unsigned tg = og / nx;
            if (og + 1u == (tg + 1u) * nx) xb_add(&bar[XB_TOPGEN], 1u);
            else XB_SPIN(xb_ld(&bar[XB_TOPGEN]) == tg, bar);
            __builtin_amdgcn_fence(__ATOMIC_ACQUIRE, "agent");
            xb_add(&bar[XB_XGEN(b.x)], 1u);
            asm volatile("s_waitcnt vmcnt(0)" ::: "memory");
        } else {
            XB_SPIN(xb_ld(&bar[XB_XGEN(b.x)]) == gen, bar);
            __builtin_amdgcn_fence(__ATOMIC_ACQUIRE, "agent");
            asm volatile("s_waitcnt vmcnt(0)" ::: "memory");
        }
    }
    __syncthreads();
}
struct Frame {
    LAS unsigned char* lds; volatile LAS unsigned* MISC; gu32* ctl;
    int tid, lane, wave, vcu, G;
};
__device__ __forceinline__ float wave_sum(float v) {
#pragma unroll
    for (int o = 1; o < 64; o <<= 1) v += __shfl_xor(v, o);
    return v;
}
__device__ __forceinline__ void p0_transpose_item(const float* W, int K, int N, bf16* WT, int dst_row0, const float* kscale, LAS float* scr, int k0, int n0, int lane) {
#pragma unroll 8
    for (int i = 0; i < 32; ++i) { const int kk = 2 * i + (lane >> 5); const float sc = kscale ? kscale[k0 + kk] : 1.0f; scr[kk * 33 + (lane & 31)] = W[(size_t)(k0 + kk) * N + n0 + (lane & 31)] * sc; }
    LDS_WAIT(); asm volatile("" ::: "memory");
    const int c = lane & 7;
#pragma unroll
    for (int j = 0; j < 4; ++j) { const int n = (lane >> 3) + 8 * j; const LAS float* s = scr + (8 * c) * 33 + n;
        v4u o; o.x = pk2(s[0 * 33], s[1 * 33]); o.y = pk2(s[2 * 33], s[3 * 33]); o.z = pk2(s[4 * 33], s[5 * 33]); o.w = pk2(s[6 * 33], s[7 * 33]);
        *(GAS v4u*)(WT + (size_t)(dst_row0 + n) * K + k0 + 8 * c) = o; }
    LDS_WAIT(); asm volatile("" ::: "memory");
}

struct Args { const float* in[16]; float* out; unsigned char* ws; };
__global__ void __launch_bounds__(NWAVES * 64, 2) mk_fwd(Args args) {
    extern __shared__ __attribute__((aligned(16))) unsigned char lds[];
    Frame F;
    F.lds = (LAS unsigned char*)lds; F.MISC = (volatile LAS unsigned*)(F.lds + MISC_OFF);
    F.tid = threadIdx.x; F.lane = F.tid & 63; F.wave = __builtin_amdgcn_readfirstlane(F.tid >> 6);
    F.G = gridDim.x; { const int bx = blockIdx.x; F.vcu = (F.G % 8 == 0) ? (bx % 8) * (F.G / 8) + bx / 8 : bx; }
    unsigned char* ws = args.ws; F.ctl = (gu32*)(ws + WS_CTL);
    const float* x = args.in[0]; const float* rel_bias = args.in[1]; const float* norm_mix = args.in[2]; const float* w_in = args.in[3];
    const float* lng = args.in[4]; const float* lnb = args.in[5]; const float* wspf = args.in[6]; const float* bsp = args.in[7];
    const float* onb = args.in[8]; const float* ona = args.in[9]; const float* w_out = args.in[10]; const float* norm_ffn = args.in[11];
    const float* w_gate = args.in[12]; const float* w_up = args.in[13]; const float* w_down = args.in[14]; const float* norm_final = args.in[15];
    float* out = args.out;
    bf16* WIN_T = (bf16*)(ws + WS_WIN); bf16* WOUT_T = (bf16*)(ws + WS_WOUT); bf16* W1_T = (bf16*)(ws + WS_W1); bf16* W2_T = (bf16*)(ws + WS_W2); bf16* WSPB = (bf16*)(ws + WS_WSP);
    bf16* XN = (bf16*)(ws + WS_XN); bf16* PB = (bf16*)(ws + WS_PB); bf16* YB = (bf16*)(ws + WS_YB); bf16* HB = (bf16*)(ws + WS_HB);
    float* KSUM = (float*)(ws + WS_KSUM); float* ZST = (float*)(ws + WS_ZST); float* SSQB = (float*)(ws + WS_SSQB); float* SSQA = (float*)(ws + WS_SSQA); float* SSQ1 = (float*)(ws + WS_SSQ1);
    for (int u = F.tid; u < (LDS_BYTES - TAB_OFF) / 4; u += NWAVES * 64) ((LAS unsigned*)(F.lds + TAB_OFF))[u] = 0u;
    __syncthreads();
    XcdBarrier bar = xcd_barrier_post((unsigned*)(F.ctl + CW_BAR), F.MISC + 8);
    LAS float* TAB = (LAS float*)(F.lds + TAB_OFF);
    const int gw = F.vcu * NWAVES + F.wave, NGW = F.G * NWAVES;

    {
        LAS float* scr = (LAS float*)(F.lds + RING_OFF + F.wave * 16384);
        constexpr int I_IN = (DM / 64) * (DPJ / 32), I_OUT = (DM / 64) * (DM / 32), I_G = (DM / 64) * (FF / 32), I_D = (FF / 64) * (DM / 32);
        constexpr int NITEMS = I_IN + I_OUT + 2 * I_G + I_D;
        for (int it = gw; it < NITEMS; it += NGW) {
            int r = it;
            if (r < I_IN) { const int nb = DPJ / 32, kb = r / nb, n0 = (r % nb) * 32; p0_transpose_item(w_in, DM, DPJ, WIN_T, n0, nullptr, scr, 64 * kb, n0, F.lane); continue; } r -= I_IN;
            if (r < I_OUT) { const int nb = DM / 32, kb = r / nb, n0 = (r % nb) * 32, k0 = 64 * kb; p0_transpose_item(w_out, DM, DM, WOUT_T, n0, (k0 < 512) ? onb : (ona - 512), scr, k0, n0, F.lane); continue; } r -= I_OUT;
            if (r < 2 * I_G) { const bool up = r >= I_G; if (up) r -= I_G; const int nb = FF / 32, kb = r / nb, n0 = (r % nb) * 32;
                p0_transpose_item(up ? w_up : w_gate, DM, FF, W1_T, (n0 / 128) * 256 + (n0 % 128) + (up ? 128 : 0), norm_ffn, scr, 64 * kb, n0, F.lane); continue; } r -= 2 * I_G;
            { const int nb = DM / 32, kb = r / nb, n0 = (r % nb) * 32; p0_transpose_item(w_down, FF, DM, W2_T, n0, nullptr, scr, 64 * kb, n0, F.lane); }
        }
        for (int idx = (F.vcu * NWAVES * 64 + F.tid); idx < 8 * 128 * 128; idx += F.G * NWAVES * 64) { const int t = (idx >> 7) & 127, s = idx & 127; WSPB[idx] = (bf16)((s <= t) ? f2bf(wspf[idx]) : 0u); }
        {   const GAS f32x4* gp = (const GAS f32x4*)norm_mix + F.lane; f32x4 gv[4];
#pragma unroll
            for (int j = 0; j < 4; ++j) gv[j] = gp[64 * j];
            for (int m = gw; m < M; m += NGW) { const GAS f32x4* xr = (const GAS f32x4*)(x + (size_t)m * DM) + F.lane; f32x4 v[4]; float s2 = 0.f;
#pragma unroll
                for (int j = 0; j < 4; ++j) { v[j] = xr[64 * j]; s2 += (v[j].x * v[j].x + v[j].y * v[j].y) + (v[j].z * v[j].z + v[j].w * v[j].w); }
                const float rstd = 1.f / sqrtf(wave_sum(s2) * (1.f / DM) + EPS);
                GAS unsigned long long* o8 = (GAS unsigned long long*)(XN + (size_t)m * DM) + F.lane;
#pragma unroll
                for (int j = 0; j < 4; ++j) { const f32x4 w = v[j] * rstd * gv[j]; o8[64 * j] = (unsigned long long)pk2(w.x, w.y) | ((unsigned long long)pk2(w.z, w.w) << 32); } }
        }
    }
    xcd_barrier(bar);

    {
        pg8::Gemm g{XN, WIN_T, M, DPJ, DM}; pg8::StaticOrder S; S.init(M, DPJ, F.G, (int)blockIdx.x);
        pg8::EpiInProj E{PB, KSUM, ZST, att::C2};
        pg8::gemm_phase<pg8::EpiInProj, pg8::StaticOrder, true, true>(F.lds + RING_OFF, g, S, E);
    }
    xcd_barrier(bar);

    {
        for (int p = F.vcu; p < 256; p += F.G) { const int bh = p >> 2, s = p & 3;
            att::moba_unit(bh >> 3, bh & 7, 7 - s, PB, KSUM, rel_bias, YB, SSQB, (LAS char*)(F.lds + RING_OFF));
            att::moba_unit(bh >> 3, bh & 7, s, PB, KSUM, rel_bias, YB, SSQB, (LAS char*)(F.lds + RING_OFF)); }
        for (int it = F.vcu; it < 1024; it += F.G) { const int g = it & 7, c = (it >> 3) & 15, b = it >> 7;
            att::gmlp_item(b, c, g, PB, ZST, lng, lnb, WSPB, bsp, YB, SSQA, (LAS char*)(F.lds + RING_OFF)); }
    }
    xcd_barrier(bar);

    {
        pg8::Gemm g{YB, WOUT_T, M, DM, DM}; pg8::StaticOrder S; S.init(M, DM, F.G, (int)blockIdx.x);
        pg8::Unit u;
        for (int i = 0; i < 4 && S.next(i, u); ++i) if (F.tid < 256) { const size_t row = (size_t)u.pm * 256 + F.tid;
            const f32x4* pb = (const f32x4*)(SSQB + row * 8); const f32x4* pa = (const f32x4*)(SSQA + row * 8);
            const f32x4 b0 = pb[0], b1 = pb[1], a0 = pa[0], a1 = pa[1];
            const float sb = ((b0.x + b0.y) + (b0.z + b0.w)) + ((b1.x + b1.y) + (b1.z + b1.w)), sa = ((a0.x + a0.y) + (a0.z + a0.w)) + ((a1.x + a1.y) + (a1.z + a1.w));
            const float rb = 1.f / sqrtf(sb * (1.f / 512.f) + EPS), ra = 1.f / sqrtf(sa * (1.f / 512.f) + EPS);
            TAB[i * 512 + F.tid] = rb / ra; TAB[i * 512 + 256 + F.tid] = ra; }
        __syncthreads();
        pg8::EpiOutProj E{x, out, XN, SSQ1, TAB};
        pg8::gemm_phase<pg8::EpiOutProj, pg8::StaticOrder, true, true>(F.lds + RING_OFF, g, S, E);
    }
    xcd_barrier(bar);

    {
        pg8::Gemm g{XN, W1_T, M, 2 * FF, DM}; pg8::StaticOrder S; S.init(M, 2 * FF, F.G, (int)blockIdx.x);
        pg8::Unit u;
        for (int i = 0; i < 8 && S.next(i, u); ++i) if (F.tid < 256) { const size_t row = (size_t)u.pm * 256 + F.tid; const f32x4* ps = (const f32x4*)(SSQ1 + row * 16);
            const f32x4 a = ps[0], b = ps[1], c = ps[2], d = ps[3];
            const float ss = (((a.x + a.y) + (a.z + a.w)) + ((b.x + b.y) + (b.z + b.w))) + (((c.x + c.y) + (c.z + c.w)) + ((d.x + d.y) + (d.z + d.w)));
            TAB[i * 256 + F.tid] = 1.f / sqrtf(ss * (1.f / DM) + EPS); }
        __syncthreads();
        pg8::EpiSwiGLU E{HB, TAB};
        pg8::gemm_phase<pg8::EpiSwiGLU, pg8::StaticOrder, true, true>(F.lds + RING_OFF, g, S, E);
    }
    xcd_barrier(bar);

    {
        pg8::Gemm g{HB, W2_T, M, DM, FF}; pg8::StaticOrder S; S.init(M, DM, F.G, (int)blockIdx.x);
        pg8::EpiDown E{out};
        pg8::gemm_phase<pg8::EpiDown, pg8::StaticOrder, true, true>(F.lds + RING_OFF, g, S, E);
    }
    xcd_barrier(bar);

    {
        const unsigned poison = __hip_atomic_load((gu32*)((unsigned*)(F.ctl + CW_BAR) + XB_TMO), RLX_AGENT);
        const GAS f32x4* gp = (const GAS f32x4*)norm_final + F.lane; f32x4 gv[4];
#pragma unroll
        for (int j = 0; j < 4; ++j) gv[j] = gp[64 * j];
        for (int m = gw; m < M; m += NGW) { GAS f32x4* xr = (GAS f32x4*)(out + (size_t)m * DM) + F.lane; f32x4 v[4]; float s2 = 0.f;
#pragma unroll
            for (int j = 0; j < 4; ++j) { v[j] = xr[64 * j]; s2 += (v[j].x * v[j].x + v[j].y * v[j].y) + (v[j].z * v[j].z + v[j].w * v[j].w); }
            float rstd = 1.f / sqrtf(wave_sum(s2) * (1.f / DM) + EPS); if (poison) rstd = __builtin_nanf("");
#pragma unroll
            for (int j = 0; j < 4; ++j) xr[64 * j] = v[j] * rstd * gv[j]; }
    }
}

extern "C" void kernel_launch(void* const* d_in, const int* in_sizes, int n_in, void* d_out, int out_size, void* d_ws, size_t ws_size, hipStream_t stream) {
    static int grid = 0;
    if (grid == 0) {
        if (n_in != 16 || in_sizes[0] != M * DM || out_size != M * DM || ws_size < WS_END) { fprintf(stderr, "kernel_launch: unexpected shapes (n_in %d, in0 %d, out %d, ws %zu); nothing launched\n", n_in, n_in > 0 ? in_sizes[0] : -1, out_size, ws_size); grid = -1; return; }
        int dev = 0, cus = 0, per_cu = 0;
        if (hipGetDevice(&dev) != hipSuccess || hipDeviceGetAttribute(&cus, hipDeviceAttributeMultiprocessorCount, dev) != hipSuccess) { fprintf(stderr, "kernel_launch: hipGetDevice / hipDeviceGetAttribute failed\n"); grid = -1; return; }
        if (hipFuncSetAttribute((const void*)mk_fwd, hipFuncAttributeMaxDynamicSharedMemorySize, LDS_BYTES) != hipSuccess) { fprintf(stderr, "kernel_launch: hipFuncSetAttribute failed\n"); grid = -1; return; }
        if (hipOccupancyMaxActiveBlocksPerMultiprocessor(&per_cu, (const void*)mk_fwd, NWAVES * 64, LDS_BYTES) != hipSuccess || per_cu < 1)
            fprintf(stderr, "kernel_launch: note: occupancy query reports %d workgroups per CU\n", per_cu);
        (void)hipGetLastError();
        grid = cus;
        if (grid > 256) grid = 256;
    }
    if (grid < 0) return;
    if (hipMemsetAsync((char*)d_ws + WS_CTL, 0, CTL_ZERO_BYTES, stream) != hipSuccess) { fprintf(stderr, "kernel_launch: hipMemsetAsync failed\n"); return; }
    Args a{};
    for (int i = 0; i < 16; ++i) a.in[i] = (const float*)d_in[i];
    a.out = (float*)d_out; a.ws = (unsigned char*)d_ws;
    hipLaunchKernelGGL(mk_fwd, dim3(grid), dim3(NWAVES * 64), LDS_BYTES, stream, a);
    const hipError_t le = hipPeekAtLastError();
    if (le != hipSuccess) fprintf(stderr, "kernel_launch: launch failed: %s\n", hipGetErrorName(le));
}
```
